# Optimizing an MI355X kernel written in HIP

```python
import jax, jax.numpy as jnp
from jax import lax
import numpy as np

D_MODEL = 1024
BATCH = 8
SEQ = 2048
DEPTH = 2

N_A_LAYERS = DEPTH // 2
N_B_LAYERS = DEPTH - N_A_LAYERS
GLA_HEADS = 4
GLA_KEY_DIM = D_MODEL // 2
GLA_VAL_DIM = D_MODEL
GLA_HEAD_K = GLA_KEY_DIM // GLA_HEADS
GLA_HEAD_V = GLA_VAL_DIM // GLA_HEADS
GLA_GATE_RANK = 16
GLA_GATE_NORMALIZER = 16.0
GLA_CHUNK = 64
GLA_SPLITS = [GLA_KEY_DIM, 2 * GLA_KEY_DIM, 2 * GLA_KEY_DIM + GLA_VAL_DIM, 2 * GLA_KEY_DIM + 2 * GLA_VAL_DIM]
GLA_IN_DIM = 2 * GLA_KEY_DIM + 2 * GLA_VAL_DIM + GLA_GATE_RANK
SB_HEADS = 16
SB_HEAD_DIM = D_MODEL // SB_HEADS
SB_WIDTH = SB_HEADS * SB_HEAD_DIM
SB_QBLOCK = 128
RMS_EPS = 1e-6

kernel_name = 'yoco_gla_stickbreaking_adaln'


def rms_norm(x, gain):
    x32 = x.astype(jnp.float32)
    y = x32 * lax.rsqrt(jnp.mean(x32 * x32, axis=-1, keepdims=True) + RMS_EPS)
    return (y * gain.astype(jnp.float32)).astype(x.dtype)


def ada_modulate(c, w, b, n):
    cond = jax.nn.silu(c) @ w + b
    return jnp.split(cond[:, None, :], n, axis=-1)


def gla_mixer(h, w_in, w_gk2, b_gk, o_gain, w_out):
    bsz, seq, _ = h.shape
    n_chunks = seq // GLA_CHUNK
    f32 = jnp.float32
    proj = h @ w_in
    q, k, v, g, gk_lr = jnp.split(proj, GLA_SPLITS, axis=-1)
    gk = jax.nn.log_sigmoid((gk_lr @ w_gk2 + b_gk).astype(f32)) / GLA_GATE_NORMALIZER

    def chunked(t, dh):
        return t.astype(f32).reshape(bsz, n_chunks, GLA_CHUNK, GLA_HEADS, dh).transpose(0, 3, 1, 2, 4)

    q = chunked(q, GLA_HEAD_K) * (GLA_HEAD_K ** -0.5)
    k = chunked(k, GLA_HEAD_K)
    v = chunked(v, GLA_HEAD_V)
    b = jnp.cumsum(chunked(gk, GLA_HEAD_K), axis=3)
    b_last = b[:, :, :, -1:, :]
    q_e = q * jnp.exp(b)
    k_e = k * jnp.exp(-b)
    k_to_end = k * jnp.exp(b_last - b)
    causal = jnp.tril(jnp.ones((GLA_CHUNK, GLA_CHUNK), dtype=bool))
    scores = jnp.where(causal, jnp.einsum('bhnid,bhnjd->bhnij', q_e, k_e), 0.0)
    o_intra = jnp.einsum('bhnij,bhnjv->bhniv', scores, v)
    state_inc = jnp.einsum('bhncd,bhncv->bhndv', k_to_end, v)
    decay = jnp.exp(b_last[:, :, :, 0, :])

    def step(state, inp):
        dec, inc = inp
        return dec[..., None] * state + inc, state

    s0 = jnp.zeros((bsz, GLA_HEADS, GLA_HEAD_K, GLA_HEAD_V), f32)
    _, s_prev = lax.scan(step, s0, (jnp.moveaxis(decay, 2, 0), jnp.moveaxis(state_inc, 2, 0)))
    s_prev = jnp.moveaxis(s_prev, 0, 2)
    o = o_intra + jnp.einsum('bhncd,bhndv->bhncv', q_e, s_prev)
    o = o.transpose(0, 2, 3, 1, 4).reshape(bsz, seq, GLA_HEADS, GLA_HEAD_V)
    o = rms_norm(o, o_gain).reshape(bsz, seq, GLA_VAL_DIM) * jax.nn.silu(g.astype(f32))
    return o.astype(h.dtype) @ w_out


def stick_breaking_mixer(h, k, v, w_in, w_out):
    bsz, seq, _ = h.shape
    q, g = jnp.split(h @ w_in, 2, axis=-1)
    q = q.reshape(bsz, seq, SB_HEADS, SB_HEAD_DIM).transpose(0, 2, 1, 3)
    scale = SB_HEAD_DIM ** -0.5
    blocks = []
    for start in range(0, seq, SB_QBLOCK):
        end = start + SB_QBLOCK
        z = jnp.einsum('bhtd,bhsd->bhts', q[:, :, start:end], k[:, :, :end]).astype(jnp.float32) * scale
        t_idx = start + jnp.arange(SB_QBLOCK)[:, None]
        s_idx = jnp.arange(end)[None, :]
        strictly_before = s_idx < t_idx
        log_beta = jax.nn.log_sigmoid(z)
        log_one_minus = jnp.where(strictly_before, log_beta - z, 0.0)
        log_survive = lax.cumsum(log_one_minus, axis=3, reverse=True) - log_one_minus
        weights = jnp.where(strictly_before, jnp.exp(log_beta + log_survive), 0.0)
        blocks.append(jnp.einsum('bhts,bhsd->bhtd', weights.astype(v.dtype), v[:, :, :end]))
    o = jnp.concatenate(blocks, axis=2).transpose(0, 2, 1, 3).reshape(bsz, seq, SB_WIDTH)
    o = o * jax.nn.silu(g)
    return o @ w_out


def setup_inputs(seed: int = 0) -> dict:
    key = jax.random.key(seed)
    ks = jax.random.split(key, 20)
    f32 = jnp.float32

    def dense(k, shape, fan_in, mult=1.0):
        return jax.random.normal(k, shape, f32) * (mult * fan_in ** -0.5)

    def gain(k, shape):
        return 1.0 + 0.02 * jax.random.normal(k, shape, f32)

    def bias(k, shape):
        return 0.02 * jax.random.normal(k, shape, f32)

    D = D_MODEL
    return {
        'x': jax.random.normal(ks[0], (BATCH, SEQ, D), f32),
        'c': jax.random.normal(ks[1], (BATCH, D), f32),
        'norm_gain': gain(ks[2], (DEPTH, D)),
        'w_ada': dense(ks[3], (DEPTH, D, 3 * D), D, 0.2),
        'b_ada': bias(ks[4], (DEPTH, 3 * D)),
        'gla_w_in': dense(ks[5], (N_A_LAYERS, D, GLA_IN_DIM), D),
        'gla_w_gk2': dense(ks[6], (N_A_LAYERS, GLA_GATE_RANK, GLA_KEY_DIM), GLA_GATE_RANK),
        'gla_b_gk': bias(ks[7], (N_A_LAYERS, GLA_KEY_DIM)),
        'gla_o_gain': gain(ks[8], (N_A_LAYERS, GLA_HEAD_V)),
        'gla_w_out': dense(ks[9], (N_A_LAYERS, GLA_VAL_DIM, D), GLA_VAL_DIM),
        'kv_gain': gain(ks[10], (D,)),
        'kv_w_ada': dense(ks[11], (D, 2 * D), D, 0.2),
        'kv_b_ada': bias(ks[12], (2 * D,)),
        'w_kv': dense(ks[13], (D, 2 * SB_WIDTH), D),
        'sb_w_in': dense(ks[14], (N_B_LAYERS, D, 2 * SB_WIDTH), D),
        'sb_w_out': dense(ks[15], (N_B_LAYERS, SB_WIDTH, D), SB_WIDTH),
        'final_gain': gain(ks[16], (D,)),
    }


def reference(x, c, norm_gain, w_ada, b_ada, gla_w_in, gla_w_gk2, gla_b_gk, gla_o_gain, gla_w_out,
              kv_gain, kv_w_ada, kv_b_ada, w_kv, sb_w_in, sb_w_out, final_gain):
    bsz, seq, _ = x.shape
    for i in range(N_A_LAYERS):
        shift, scale, gate = ada_modulate(c, w_ada[i], b_ada[i], 3)
        h = rms_norm(x, norm_gain[i]) * (1.0 + scale) + shift
        x = x + gate * gla_mixer(h, gla_w_in[i], gla_w_gk2[i], gla_b_gk[i], gla_o_gain[i], gla_w_out[i])
    kv_shift, kv_scale = ada_modulate(c, kv_w_ada, kv_b_ada, 2)
    hk = rms_norm(x, kv_gain) * (1.0 + kv_scale) + kv_shift
    k_sh, v_sh = jnp.split(hk @ w_kv, 2, axis=-1)
    k_sh = k_sh.reshape(bsz, seq, SB_HEADS, SB_HEAD_DIM).transpose(0, 2, 1, 3)
    v_sh = v_sh.reshape(bsz, seq, SB_HEADS, SB_HEAD_DIM).transpose(0, 2, 1, 3)
    for j in range(N_B_LAYERS):
        l = N_A_LAYERS + j
        shift, scale, gate = ada_modulate(c, w_ada[l], b_ada[l], 3)
        h = rms_norm(x, norm_gain[l]) * (1.0 + scale) + shift
        x = x + gate * stick_breaking_mixer(h, k_sh, v_sh, sb_w_in[j], sb_w_out[j])
    return rms_norm(x, final_gain)
```

```cpp
#define MK_ONE_LAUNCH 1
#include <hip/hip_runtime.h>
#include <cstdio>
#include <cstdint>
namespace pg8 {
#define PG8_LAS __attribute__((address_space(3)))
typedef unsigned short bf16_t;
typedef short bf16x8 __attribute__((ext_vector_type(8)));
typedef float f32x4 __attribute__((ext_vector_type(4)));
typedef unsigned u32x4 __attribute__((ext_vector_type(4)));
constexpr int BM = 256, BK = 64, HALF = 128, HTB = HALF * BK * 2  , STAGE_BYTES = 8 * HTB, NXCD = 8, WGM = 8;

__host__ __device__ __forceinline__ int lds_byte(int r, int c) { const int st = (r >> 4) * 2 + (c >> 5), rr = r & 15, cc = c & 31, ob = rr * 64 + cc * 2; return st * 1024 + (ob ^ (((ob >> 9) & 1) << 5)); }
__host__ __device__ __forceinline__ void stage_rc(int b, int& R, int& C) { const int st = b / 1024, sb = b % 1024, swz = sb ^ (((sb >> 9) & 1) << 5); R = (st >> 1) * 16 + swz / 64; C = (st & 1) * 32 + (swz % 64) / 2; }
__host__ __device__ __forceinline__ int perm32(int rho) { const int n = rho >> 4, i = rho & 15; return 8 * (i >> 2) + 4 * n + (i & 3); }

struct Unit { int pm, pn; };
struct Gemm { const bf16_t* A; const bf16_t* Bt; int M, N, K; };

struct StaticOrder {
    int nM, nN, nwg, G, c;
    __host__ __device__ void init(int M, int N, int G_, int c_) { nM = M / BM; nN = N / BM; nwg = nM * nN; G = G_; c = c_; }
    __host__ __device__ bool next(int i, Unit& u) const {
        const long L = (long)i * G + c; if (L >= nwg) return false;
        int wgid = (int)L; { const int q = nwg / NXCD, r = nwg % NXCD, xcd = wgid % NXCD, off = wgid / NXCD; wgid = (xcd < r ? xcd * (q + 1) : r * (q + 1) + (xcd - r) * q) + off; }
        const int nig = WGM * nN, gid = wgid / nig, fm = gid * WGM, gsz = (nM - fm) < WGM ? (nM - fm) : WGM;
        u.pm = fm + ((wgid % nig) % gsz); u.pn = (wgid % nig) / gsz; return true;
    }
    __device__ __forceinline__ void a_ready(const Unit&) const {}
    __device__ __forceinline__ void done(const Unit&) const {}
};

__device__ __forceinline__ unsigned cvt_pk_bf16(float lo, float hi) { unsigned r; asm volatile("v_cvt_pk_bf16_f32 %0, %1, %2" : "=v"(r) : "v"(lo), "v"(hi)); return r; }
typedef float f32x2 __attribute__((ext_vector_type(2)));
__device__ __forceinline__ f32x2 gelu_pk(f32x2 v) {
    const f32x2 av = __builtin_elementwise_abs(v), d = av * 0.2316418882f + 1.0f;
    f32x2 t; t.x = __builtin_amdgcn_rcpf(d.x); t.y = __builtin_amdgcn_rcpf(d.y);
    f32x2 q = t * 0.5307027145f + (-0.7265760135f); q = q * t + 0.7107068705f; q = q * t + (-0.142248368f); q = q * t + 0.127414796f; q = q * t;
    const f32x2 s = (v * v) * (-0.72134752044f);
    f32x2 e; e.x = __builtin_amdgcn_exp2f(s.x); e.y = __builtin_amdgcn_exp2f(s.y);
    const f32x2 m = v * (q * e), r = v - m;
    f32x2 o; o.x = v.x < 0.f ? m.x : r.x; o.y = v.y < 0.f ? m.y : r.y; return o;
}

template <int ACT  > struct EpiBf16 {
    static constexpr bool PERM = true, AFTER_DRAIN = false; static_assert(ACT == 0 || ACT == 1, "EpiBf16: ACT is 0 (none) or 1 (gelu_pk)");
    bf16_t* O; int ldc; const float* bias; int split_cols; size_t split_stride; float scale0;
    __device__ __forceinline__ void operator()(const f32x4 (&acc)[2][2][4][2], const Unit& u, int wr, int wc, int fr, int fq) const {
        const int row0 = u.pm * BM + wr * 64 + fr; int colt = u.pn * BM; bf16_t* base = O;
        float sc = 1.f; if (split_cols) { const int t = colt / split_cols; base += (size_t)t * split_stride; colt -= t * split_cols; if (t == 0) sc = scale0; }
        const int col0 = colt + wc * 32 + 8 * fq, bcol0 = u.pn * BM + wc * 32 + 8 * fq;
        f32x4 bv[2][2];
#pragma unroll
        for (int bj = 0; bj < 2; ++bj)
#pragma unroll
            for (int n = 0; n < 2; ++n) bv[bj][n] = bias ? *(const f32x4*)(bias + bcol0 + bj * HALF + 4 * n) : (f32x4){0.f, 0.f, 0.f, 0.f};
#pragma unroll
        for (int ai = 0; ai < 2; ++ai)
#pragma unroll
            for (int m = 0; m < 4; ++m) { bf16_t* rowp = base + (size_t)(row0 + ai * HALF + m * 16) * ldc + col0;
#pragma unroll
                for (int bj = 0; bj < 2; ++bj) { f32x4 v0 = acc[ai][bj][m][0] + bv[bj][0], v1 = acc[ai][bj][m][1] + bv[bj][1];
                    if (ACT == 1) { f32x2 a = gelu_pk((f32x2){v0[0], v0[1]}), b = gelu_pk((f32x2){v0[2], v0[3]}), c = gelu_pk((f32x2){v1[0], v1[1]}), d = gelu_pk((f32x2){v1[2], v1[3]});
                        v0 = (f32x4){a.x, a.y, b.x, b.y}; v1 = (f32x4){c.x, c.y, d.x, d.y}; }
                    v0 = v0 * sc; v1 = v1 * sc; u32x4 w; w.x = cvt_pk_bf16(v0[0], v0[1]); w.y = cvt_pk_bf16(v0[2], v0[3]); w.z = cvt_pk_bf16(v1[0], v1[1]); w.w = cvt_pk_bf16(v1[2], v1[3]);
                    *(u32x4*)(rowp + bj * HALF) = w; } }
    }
};
struct EpiRes {
    static constexpr bool PERM = false, AFTER_DRAIN = false;
    const float* base; float* out; const float* gate; int gate_ld;
    __device__ __forceinline__ void operator()(const f32x4 (&acc)[2][2][4][2], const Unit& u, int wr, int wc, int fr, int fq) const {
        const int row0 = u.pm * BM + wr * 64 + fr, col0 = u.pn * BM + wc * 32 + 4 * fq;
        const float* gp = gate + (size_t)(u.pm >> 3) * gate_ld + col0;
        f32x4 gv[2][2];
#pragma unroll
        for (int bj = 0; bj < 2; ++bj)
#pragma unroll
            for (int n = 0; n < 2; ++n) gv[bj][n] = *(const f32x4*)(gp + bj * HALF + n * 16);
#pragma unroll
        for (int ai = 0; ai < 2; ++ai)
#pragma unroll
            for (int m = 0; m < 4; ++m) { const size_t off = (size_t)(row0 + ai * HALF + m * 16) * 1024 + col0;
#pragma unroll
                for (int bj = 0; bj < 2; ++bj)
#pragma unroll
                    for (int n = 0; n < 2; ++n) { const f32x4 bs = *(const f32x4*)(base + off + bj * HALF + n * 16);
                        *(f32x4*)(out + off + bj * HALF + n * 16) = bs + gv[bj][n] * acc[ai][bj][m][n]; } }
    }
};

template <class Epi, class Sched, bool ALIGN_EPI = false, bool SP2 = false>
__device__ __forceinline__ void gemm_phase(PG8_LAS unsigned char* lds, const Gemm g, const Sched& S, const Epi& E) {
    const int tid = threadIdx.x, wid = __builtin_amdgcn_readfirstlane(tid >> 6), lane = tid & 63, wr = wid >> 2, wc = wid & 3, fr = lane & 15, fq = lane >> 4;
    const int K = g.K, nt = K / BK;
    unsigned voffA[2], voffB[2];
#pragma unroll
    for (int i = 0; i < 2; ++i) { int R, C; stage_rc(tid * 16 + i * 8192, R, C); const int Rb = Epi::PERM ? ((R & ~31) + perm32(R & 31)) : R;
        voffA[i] = (unsigned)(R * K + C) * 2u; voffB[i] = (unsigned)(Rb * K + C) * 2u; }
    const size_t kstep = (size_t)(BK * 2);
    const size_t hstep = (size_t)HALF * K * 2;
    const size_t tstep = 2 * hstep;
    const unsigned ldsw = (unsigned)wid * 1024u;
    const int aoff = lds_byte(wr * 64 + fr, fq * 8), boff = lds_byte(wc * 32 + fr, fq * 8);
#define PG8_SA(b, h) (((b) * 2 + (h)) * HTB)
#define PG8_SB(b, h) ((4 + (b) * 2 + (h)) * HTB)
#define PG8_STAGE(bufoff, gbase, voff) do { _Pragma("unroll") for (int _i = 0; _i < 2; ++_i) \
        __builtin_amdgcn_global_load_lds((const unsigned*)((const char*)(gbase) + (voff)[_i]), (PG8_LAS unsigned*)(lds + (bufoff) + ldsw + _i * 8192), 16, 0, 0); } while (0)
#define PG8_LDA(dst, b, h) do { _Pragma("unroll") for (int m = 0; m < 4; ++m) _Pragma("unroll") for (int k = 0; k < 2; ++k) dst[m][k] = *(const PG8_LAS bf16x8*)(lds + PG8_SA(b, h) + aoff + m * 2048 + k * 1024); } while (0)
#define PG8_LDB(dst, b, h) do { _Pragma("unroll") for (int n = 0; n < 2; ++n) _Pragma("unroll") for (int k = 0; k < 2; ++k) dst[n][k] = *(const PG8_LAS bf16x8*)(lds + PG8_SB(b, h) + boff + n * 2048 + k * 1024); } while (0)
#define PG8_MMA(ai, bj, At, Bt) do { __builtin_amdgcn_s_setprio(1); _Pragma("unroll") for (int m = 0; m < 4; ++m) _Pragma("unroll") for (int n = 0; n < 2; ++n) _Pragma("unroll") for (int k = 0; k < 2; ++k) \
        acc[ai][bj][m][n] = __builtin_amdgcn_mfma_f32_16x16x32_bf16(Bt[n][k], At[m][k], acc[ai][bj][m][n], 0, 0, 0); __builtin_amdgcn_s_setprio(0); } while (0)
#define PG8_WAIT_V(n) asm volatile("s_waitcnt vmcnt(" #n ")" ::: "memory")
#define PG8_WAIT_L(n) asm volatile("s_waitcnt lgkmcnt(" #n ")" ::: "memory")
#define PG8_BAR __builtin_amdgcn_s_barrier()
#define PG8_SCHED __builtin_amdgcn_sched_barrier(0)
    Unit cur, nxt; int ui = 0;
    if (!S.next(0, cur)) return;
    f32x4 acc[2][2][4][2];
#pragma unroll
    for (int a = 0; a < 2; ++a)
#pragma unroll
        for (int b = 0; b < 2; ++b)
#pragma unroll
            for (int m = 0; m < 4; ++m)
#pragma unroll
                for (int n = 0; n < 2; ++n) acc[a][b][m][n] = (f32x4){0.f, 0.f, 0.f, 0.f};
    bf16x8 At[4][2], B0[2][2], B1[2][2];
    const char* cA = (const char*)g.A + (size_t)cur.pm * tstep; const char* cB = (const char*)g.Bt + (size_t)cur.pn * tstep;
    S.a_ready(cur);
    if constexpr (SP2) {
        PG8_STAGE(PG8_SB(0, 0), cB, voffB); PG8_STAGE(PG8_SB(0, 1), cB + hstep, voffB); PG8_STAGE(PG8_SA(0, 0), cA, voffA); PG8_STAGE(PG8_SA(0, 1), cA + hstep, voffA);
        if (wr == 1) PG8_BAR;
        PG8_WAIT_V(2); PG8_BAR;
        PG8_STAGE(PG8_SB(1, 0), cB + kstep, voffB); PG8_STAGE(PG8_SA(1, 0), cA + kstep, voffA); PG8_STAGE(PG8_SB(1, 1), cB + hstep + kstep, voffB);
        PG8_WAIT_V(6); PG8_BAR;
    } else {
        PG8_STAGE(PG8_SB(0, 0), cB, voffB); PG8_STAGE(PG8_SA(0, 0), cA, voffA); PG8_STAGE(PG8_SB(0, 1), cB + hstep, voffB); PG8_STAGE(PG8_SA(0, 1), cA + hstep, voffA);
        if (wr == 1) PG8_BAR;
        PG8_WAIT_V(4); PG8_BAR;
        PG8_STAGE(PG8_SB(1, 0), cB + kstep, voffB); PG8_STAGE(PG8_SA(1, 0), cA + kstep, voffA); PG8_STAGE(PG8_SB(1, 1), cB + hstep + kstep, voffB);
        PG8_WAIT_V(6); PG8_BAR;
    }
    for (;;) {
        const bool has_next = S.next(ui + 1, nxt);
        const char* nA = has_next ? (const char*)g.A + (size_t)nxt.pm * tstep : cA; const char* nB = has_next ? (const char*)g.Bt + (size_t)nxt.pn * tstep : cB;
        for (int t = 0; t < nt; t += 2) {
            const bool last = (t == nt - 2);
            const char* a1 = cA + (size_t)(t + 1) * kstep;
            const char* a2 = last ? nA : cA + (size_t)(t + 2) * kstep; const char* b2 = last ? nB : cB + (size_t)(t + 2) * kstep;
            const char* a3 = a2 + kstep; const char* b3 = b2 + kstep;
            if (last && has_next) S.a_ready(nxt);
            if constexpr (SP2) {
            PG8_LDB(B0, 0, 0); PG8_LDB(B1, 0, 1); PG8_SCHED; PG8_LDA(At, 0, 0); PG8_STAGE(PG8_SA(1, 1), a1 + hstep, voffA);
            PG8_WAIT_V(8); PG8_WAIT_L(0); PG8_BAR; PG8_MMA(0, 0, At, B0); PG8_MMA(0, 1, At, B1); PG8_BAR; PG8_SCHED;
            PG8_LDA(At, 0, 1); PG8_STAGE(PG8_SB(0, 0), b2, voffB); PG8_STAGE(PG8_SB(0, 1), b2 + hstep, voffB); PG8_STAGE(PG8_SA(0, 0), a2, voffA);
            PG8_WAIT_V(8); PG8_WAIT_L(0); PG8_BAR; PG8_MMA(1, 0, At, B0); PG8_MMA(1, 1, At, B1); PG8_BAR; PG8_SCHED;
            PG8_LDB(B0, 1, 0); PG8_LDB(B1, 1, 1); PG8_SCHED; PG8_LDA(At, 1, 0); PG8_STAGE(PG8_SA(0, 1), a2 + hstep, voffA);
            PG8_WAIT_V(8); PG8_WAIT_L(0); PG8_BAR; PG8_MMA(0, 0, At, B0); PG8_MMA(0, 1, At, B1); PG8_BAR; PG8_SCHED;
            PG8_LDA(At, 1, 1); PG8_STAGE(PG8_SB(1, 0), b3, voffB); PG8_STAGE(PG8_SB(1, 1), b3 + hstep, voffB); PG8_STAGE(PG8_SA(1, 0), a3, voffA);
            PG8_WAIT_V(8); PG8_WAIT_L(0); PG8_BAR; PG8_MMA(1, 0, At, B0); PG8_MMA(1, 1, At, B1); PG8_BAR; PG8_SCHED;
            } else {
            PG8_LDB(B0, 0, 0); PG8_SCHED; PG8_LDA(At, 0, 0); PG8_STAGE(PG8_SA(1, 1), a1 + hstep, voffA);
            PG8_WAIT_L(8); PG8_BAR; PG8_WAIT_L(0); PG8_MMA(0, 0, At, B0); PG8_BAR; PG8_SCHED;
            PG8_LDB(B1, 0, 1); PG8_STAGE(PG8_SB(0, 0), b2, voffB);
            PG8_BAR; PG8_WAIT_L(0); PG8_MMA(0, 1, At, B1); PG8_BAR;
            PG8_LDA(At, 0, 1); PG8_STAGE(PG8_SA(0, 0), a2, voffA);
            PG8_BAR; PG8_WAIT_L(0); PG8_MMA(1, 0, At, B0); PG8_BAR; PG8_SCHED;
            PG8_STAGE(PG8_SB(0, 1), b2 + hstep, voffB);
            PG8_WAIT_V(6); PG8_BAR; PG8_MMA(1, 1, At, B1); PG8_BAR;
            PG8_LDB(B0, 1, 0); PG8_SCHED; PG8_LDA(At, 1, 0); PG8_STAGE(PG8_SA(0, 1), a2 + hstep, voffA);
            PG8_WAIT_L(8); PG8_BAR; PG8_WAIT_L(0); PG8_MMA(0, 0, At, B0); PG8_BAR; PG8_SCHED;
            PG8_LDB(B1, 1, 1); PG8_STAGE(PG8_SB(1, 0), b3, voffB);
            PG8_BAR; PG8_WAIT_L(0); PG8_MMA(0, 1, At, B1); PG8_BAR;
            PG8_LDA(At, 1, 1); PG8_STAGE(PG8_SA(1, 0), a3, voffA);
            PG8_BAR; PG8_WAIT_L(0); PG8_MMA(1, 0, At, B0); PG8_BAR; PG8_SCHED;
            PG8_STAGE(PG8_SB(1, 1), b3 + hstep, voffB);
            PG8_WAIT_V(6); PG8_BAR; PG8_MMA(1, 1, At, B1); PG8_BAR;
            }
        }
        if constexpr (ALIGN_EPI) { if (wr == 0) PG8_BAR; }
        if constexpr (!Epi::AFTER_DRAIN) { E(acc, cur, wr, wc, fr, fq); S.done(cur); }
        if (!has_next) break;
#pragma unroll
        for (int a = 0; a < 2; ++a)
#pragma unroll
            for (int b = 0; b < 2; ++b)
#pragma unroll
                for (int m = 0; m < 4; ++m)
#pragma unroll
                    for (int n = 0; n < 2; ++n) acc[a][b][m][n] = (f32x4){0.f, 0.f, 0.f, 0.f};
        cur = nxt; cA = nA; cB = nB; ++ui;
        if constexpr (ALIGN_EPI) { if (wr == 1) PG8_BAR; }
    }
    PG8_WAIT_V(0);
    if constexpr (!ALIGN_EPI) { if (wr == 0) PG8_BAR; }
    PG8_BAR;
    if constexpr (Epi::AFTER_DRAIN) { E.fused(acc, cur, wr, wc, fr, fq, lds, wid, lane); S.done(cur); }
#undef PG8_SA
#undef PG8_SB
#undef PG8_STAGE
#undef PG8_LDA
#undef PG8_LDB
#undef PG8_MMA
#undef PG8_WAIT_V
#undef PG8_WAIT_L
#undef PG8_BAR
#undef PG8_SCHED
}
}
#define GAS __attribute__((address_space(1)))
#define LAS __attribute__((address_space(3)))
typedef unsigned short bf16;
typedef unsigned v4u __attribute__((ext_vector_type(4)));
typedef float f32x4 __attribute__((ext_vector_type(4)));
typedef short bf16x8 __attribute__((ext_vector_type(8)));
typedef GAS unsigned gu32;
typedef GAS unsigned long long gu64;
#define RLX_AGENT __ATOMIC_RELAXED, __HIP_MEMORY_SCOPE_AGENT
#define LDS_WAIT() asm volatile("s_waitcnt lgkmcnt(0)" ::: "memory")
#define VM_WAIT() asm volatile("s_waitcnt vmcnt(0)" ::: "memory")
__device__ __forceinline__ unsigned long long rt() { return __builtin_amdgcn_s_memrealtime(); }
__device__ __forceinline__ unsigned f2bf(float f) { unsigned u = __builtin_bit_cast(unsigned, f); return (u + 0x7fffu + ((u >> 16) & 1u)) >> 16; }
__device__ __forceinline__ unsigned pk2(float lo, float hi) { return f2bf(lo) | (f2bf(hi) << 16); }

#define XB_TMO      128
#define XB_XCNT(j)  (256  + 64 * (j))
#define XB_XSUB(j)  (1280 + 64 * (j))
#define XB_XGEN(j)  (2304 + 64 * (j))
#define XB_TOP      3328
#define XB_TOPGEN   3392
#define XCD_BAR_WORDS 3456
#define XB_SPIN_CAP (1u << 18)

__device__ __forceinline__ unsigned xb_ld(unsigned* p)              { return __hip_atomic_load(p, __ATOMIC_RELAXED, __HIP_MEMORY_SCOPE_AGENT); }
__device__ __forceinline__ unsigned xb_add(unsigned* p, unsigned v) { return __hip_atomic_fetch_add(p, v, __ATOMIC_RELAXED, __HIP_MEMORY_SCOPE_AGENT); }
__device__ __forceinline__ unsigned xb_xcc_id() { return (unsigned)__builtin_amdgcn_s_getreg((3 << 11) | 20) & 0xFu; }
#define XB_SPIN(cond, bar) do { unsigned _sp = 0; while (cond) { __builtin_amdgcn_s_sleep(1); \
    if ((++_sp & 255u) == 0u) { if (xb_ld(&(bar)[XB_TMO])) break; if (_sp > XB_SPIN_CAP) { atomicAdd(&(bar)[XB_TMO], 1u); break; } } } } while (0)

struct XcdBarrier {
    unsigned* bar; unsigned x;
    volatile LAS unsigned* st;
};

__device__ __forceinline__ XcdBarrier xcd_barrier_post(unsigned* bar, volatile LAS unsigned* st) {
    XcdBarrier b; b.bar = bar; b.x = xb_xcc_id(); b.st = st;
    if (threadIdx.x == 0) (void)xb_add(&bar[XB_XCNT(b.x)], 1u);
    return b;
}
__device__ __forceinline__ void xcd_barrier_complete(unsigned* bar, unsigned x, unsigned& nloc, unsigned& nx) {
    const unsigned G = gridDim.x * gridDim.y * gridDim.z;
    unsigned sum, cnt, mine, sp = 0u;
    for (;;) {
        sum = 0u; cnt = 0u; mine = 0u;
#pragma unroll
        for (unsigned j = 0; j < 16; ++j) { const unsigned c = xb_ld(&bar[XB_XCNT(j)]); sum += c; cnt += (c > 0u) ? 1u : 0u; mine = (j == x) ? c : mine; }
        if (sum == G) break;
        __builtin_amdgcn_s_sleep(1);
        if ((++sp & 255u) == 0u) { if (xb_ld(&bar[XB_TMO])) break; if (sp > XB_SPIN_CAP) { atomicAdd(&bar[XB_TMO], 1u); break; } }
    }
    nloc = mine > 0u ? mine : 1u; nx = cnt > 0u ? cnt : 1u;
}

__device__ __forceinline__ void xcd_barrier(const XcdBarrier& b) {
    asm volatile("s_waitcnt vmcnt(0)" ::: "memory");
    __syncthreads();
    if (threadIdx.x == 0) {
        unsigned* bar = b.bar;
        __builtin_amdgcn_s_waitcnt(0);
        unsigned nloc = b.st[0], nx = b.st[1];
        if (nloc == 0u) { xcd_barrier_complete(bar, b.x, nloc, nx); b.st[0] = nloc; b.st[1] = nx; }
        const unsigned old = xb_add(&bar[XB_XSUB(b.x)], 1u);
        const unsigned gen = old / nloc;
        if (old + 1u == (gen + 1u) * nloc) {
            __builtin_amdgcn_fence(__ATOMIC_RELEASE, "agent");
            asm volatile("s_waitcnt vmcnt(0)" ::: "memory");
            const unsigned og = xb_add(&bar[XB_TOP], 1u);
            const unsigned tg = og / nx;
            if (og + 1u == (tg + 1u) * nx) xb_add(&bar[XB_TOPGEN], 1u);
            else XB_SPIN(xb_ld(&bar[XB_TOPGEN]) == tg, bar);
            __builtin_amdgcn_fence(__ATOMIC_ACQUIRE, "agent");
            xb_add(&bar[XB_XGEN(b.x)], 1u);
            asm volatile("s_waitcnt vmcnt(0)" ::: "memory");
        } else {
            XB_SPIN(xb_ld(&bar[XB_XGEN(b.x)]) == gen, bar);
            __builtin_amdgcn_fence(__ATOMIC_ACQUIRE, "agent");
            asm volatile("s_waitcnt vmcnt(0)" ::: "memory");
        }
    }
    __syncthreads();
}

constexpr int NWAVES = 8, NTHR = 512;
constexpr int BATCH = 8, T = 2048, D = 1024, M = BATCH * T;
constexpr int GIN = 3088, NQKVG = 3072;
constexpr int NCOND = 8192;
constexpr int KS_ADA = 16;
constexpr float RMS_EPS = 1e-6f;
constexpr float GLA_QSCALE = 0.08838834764831845f;
constexpr float SB_EXIT = 40.0f;

constexpr size_t MiB = 1u << 20;
constexpr size_t WS_CTL = 0, CTL_ZERO_BYTES = 1 * MiB;
constexpr size_t WS_WIN = 2 * MiB, WS_WOUT = 8 * MiB, WS_WKV = 10 * MiB, WS_WSBI = 14 * MiB, WS_WSBO = 18 * MiB;
constexpr size_t WS_CONDP = 20 * MiB;
constexpr size_t WS_COND = 24 * MiB;
constexpr size_t WS_GKLR = 25 * MiB;
constexpr size_t WS_DEC = 26 * MiB;
constexpr size_t WS_XN = 32 * MiB;
constexpr size_t WS_QE = 32 * MiB, WS_KTET = 48 * MiB;
constexpr size_t WS_QKVG = 64 * MiB;
constexpr size_t WS_KV = 64 * MiB, WS_QG = 128 * MiB;
constexpr size_t WS_O = 160 * MiB;
constexpr size_t WS_OG = 192 * MiB;
constexpr size_t WS_ON = 224 * MiB;
constexpr size_t WS_END = 256 * MiB;
constexpr int CW_BAR = 4096;

constexpr int RING_BYTES = 131072;
constexpr int LDSCTL_OFF = RING_BYTES, MISC_OFF = LDSCTL_OFF + 320;
constexpr int LDS_BYTES = 147456;

typedef float f32x16 __attribute__((ext_vector_type(16)));
typedef unsigned u32x2 __attribute__((ext_vector_type(2)));

__device__ __forceinline__ float bf2f(unsigned short h) { return __uint_as_float(((unsigned)h) << 16); }
__device__ __forceinline__ float bflo(unsigned w) { return __uint_as_float(w << 16); }
__device__ __forceinline__ float bfhi(unsigned w) { return __uint_as_float(w & 0xffff0000u); }
__device__ __forceinline__ int crow(int r, int hi) { return (r & 3) + 8 * (r >> 2) + 4 * hi; }
__device__ __forceinline__ float wave_sum(float v) {
#pragma unroll
    for (int o = 1; o < 64; o <<= 1) v += __shfl_xor(v, o);
    return v;
}
__device__ __forceinline__ float silu_f(float v) { return v / (1.f + __expf(-v)); }
__device__ __forceinline__ float softplus_f(float z) { return fmaxf(z, 0.f) + __logf(1.f + __expf(-fabsf(z))); }
__device__ __forceinline__ f32x16 mfma32(bf16x8 a, bf16x8 b, f32x16 c) { return __builtin_amdgcn_mfma_f32_32x32x16_bf16(a, b, c, 0, 0, 0); }
__device__ __forceinline__ bf16x8 pack8(float a0, float a1, float a2, float a3, float a4, float a5, float a6, float a7) {
    v4u w; w.x = pk2(a0, a1); w.y = pk2(a2, a3); w.z = pk2(a4, a5); w.w = pk2(a6, a7); return __builtin_bit_cast(bf16x8, w);
}

struct Frame {
    LAS unsigned char* lds;
    volatile LAS unsigned* MISC;
    gu32* ctl;
    int tid, lane, wave, vcu, G;
    const float *x, *c, *norm_gain, *w_ada, *b_ada, *gla_w_in, *gla_w_gk2, *gla_b_gk, *gla_o_gain, *gla_w_out, *kv_gain, *kv_w_ada, *kv_b_ada, *w_kv, *sb_w_in, *sb_w_out, *final_gain;
    float* out;
    bf16 *Win_t, *Wout_t, *Wkv_t, *Wsbi_t, *Wsbo_t;
    float *condp, *cond, *gklr, *dec, *O;
    bf16 *XN, *QE, *KTET, *QKVG, *KV, *QG, *OG, *ON, *VT, *XNKV, *XNSB;
};

__device__ __forceinline__ void p0_transpose_item(const float* W, int K, int N, int ldw, bf16* WT, LAS float* scr, int item, int lane) {
    const int nblk = N / 32, kb = item / nblk, nb = item % nblk, k0 = 64 * kb, n0 = 32 * nb;
#pragma unroll 8
    for (int i = 0; i < 32; ++i) { const int kk = 2 * i + (lane >> 5); scr[kk * 33 + (lane & 31)] = W[(size_t)(k0 + kk) * ldw + n0 + (lane & 31)]; }
    LDS_WAIT(); asm volatile("" ::: "memory");
    const int c = lane & 7;
#pragma unroll
    for (int j = 0; j < 4; ++j) { const int n = (lane >> 3) + 8 * j; const LAS float* s = scr + (8 * c) * 33 + n;
        v4u o; o.x = pk2(s[0 * 33], s[1 * 33]); o.y = pk2(s[2 * 33], s[3 * 33]); o.z = pk2(s[4 * 33], s[5 * 33]); o.w = pk2(s[6 * 33], s[7 * 33]);
        *(GAS v4u*)(WT + (size_t)(n0 + n) * K + k0 + 8 * c) = o; }
    LDS_WAIT(); asm volatile("" ::: "memory");
}
__device__ __forceinline__ void p0_prologue(Frame& F) {
    const int gw = F.vcu * NWAVES + F.wave, NGW = F.G * NWAVES, lane = F.lane;
    for (int it = gw; it < 128 * KS_ADA; it += NGW) {
        const int cg = it & 127, ks = it >> 7, n = cg * 64 + lane, k0 = ks * 64;
        const float* W; int ld, col;
        if (n < 6144) { const int l = (cg * 64) / 3072; col = n - l * 3072; W = F.w_ada + (size_t)l * 1024 * 3072; ld = 3072; } else { col = n - 6144; W = F.kv_w_ada; ld = 2048; }
        float sc[8], acc[8];
#pragma unroll
        for (int b = 0; b < 8; ++b) { sc[b] = silu_f(F.c[b * 1024 + k0 + lane]); acc[b] = 0.f; }
#pragma unroll 16
        for (int k = 0; k < 64; ++k) { const float w = W[(size_t)(k0 + k) * ld + col];
#pragma unroll
            for (int b = 0; b < 8; ++b) acc[b] += __int_as_float(__builtin_amdgcn_readlane(__float_as_int(sc[b]), k)) * w; }
#pragma unroll
        for (int b = 0; b < 8; ++b) F.condp[(size_t)(ks * 8 + b) * NCOND + n] = acc[b];
    }
    LAS float* scr = (LAS float*)(F.lds + F.wave * 16384);
    constexpr int I_IN = 16 * (NQKVG / 32), I_OUT = 16 * 32, I_KV = 16 * 64, I_SBI = 16 * 64, I_SBO = 16 * 32;
    constexpr int NITEMS = I_IN + I_OUT + I_KV + I_SBI + I_SBO;
    for (int it = gw; it < NITEMS; it += NGW) {
        int r = it;
        if (r < I_IN) { p0_transpose_item(F.gla_w_in, D, NQKVG, GIN, F.Win_t, scr, r, lane); continue; } r -= I_IN;
        if (r < I_OUT) { p0_transpose_item(F.gla_w_out, D, 1024, 1024, F.Wout_t, scr, r, lane); continue; } r -= I_OUT;
        if (r < I_KV) { p0_transpose_item(F.w_kv, D, 2048, 2048, F.Wkv_t, scr, r, lane); continue; } r -= I_KV;
        if (r < I_SBI) { p0_transpose_item(F.sb_w_in, D, 2048, 2048, F.Wsbi_t, scr, r, lane); continue; } r -= I_SBI;
        p0_transpose_item(F.sb_w_out, D, 1024, 1024, F.Wsbo_t, scr, r, lane);
    }
}

__device__ __forceinline__ void p1_xnorm(Frame& F) {
    LAS float* CS = (LAS float*)(F.lds); LAS float* SHT = CS + 1024; LAS float* WG = CS + 2048;
    const int lane = F.lane;
    for (int idx = F.tid; idx < 16384; idx += NTHR) { const int k = idx >> 4, r = idx & 15; WG[r * 1024 + k] = F.gla_w_in[(size_t)k * GIN + NQKVG + r]; }
    for (int idx = F.vcu * NTHR + F.tid; idx < BATCH * NCOND; idx += F.G * NTHR) { const int n = idx & (NCOND - 1); float s = (n < 6144) ? F.b_ada[n] : F.kv_b_ada[n - 6144];
#pragma unroll
        for (int ks = 0; ks < KS_ADA; ++ks) s += F.condp[(size_t)ks * (BATCH * NCOND) + idx];
        F.cond[idx] = s; }
    for (int rb = F.vcu; rb < M / 64; rb += F.G) {
        const int b = rb >> 5;
        __syncthreads();
        for (int k = F.tid; k < 1024; k += NTHR) { float sh = F.b_ada[k], sc = F.b_ada[1024 + k];
#pragma unroll
            for (int ks = 0; ks < KS_ADA; ++ks) { const float* p = F.condp + (size_t)(ks * 8 + b) * NCOND; sh += p[k]; sc += p[1024 + k]; }
            CS[k] = F.norm_gain[k] * (1.f + sc); SHT[k] = sh; }
        __syncthreads();
        for (int i = 0; i < 8; ++i) {
            const int row = rb * 64 + F.wave * 8 + i;
            const GAS f32x4* xr = (const GAS f32x4*)(F.x + (size_t)row * D) + lane;
            f32x4 v[4]; float ss = 0.f;
#pragma unroll
            for (int j = 0; j < 4; ++j) { v[j] = xr[64 * j]; ss += (v[j].x * v[j].x + v[j].y * v[j].y) + (v[j].z * v[j].z + v[j].w * v[j].w); }
            const float rstd = rsqrtf(wave_sum(ss) * (1.f / D) + RMS_EPS);
            float a[16];
#pragma unroll
            for (int r = 0; r < 16; ++r) a[r] = 0.f;
            GAS unsigned long long* o8 = (GAS unsigned long long*)(F.XN + (size_t)row * D) + lane;
#pragma unroll
            for (int j = 0; j < 4; ++j) {
                const f32x4 cs = ((LAS f32x4*)CS)[lane + 64 * j], sh = ((LAS f32x4*)SHT)[lane + 64 * j];
                const f32x4 hh = v[j] * rstd * cs + sh;
                o8[64 * j] = (unsigned long long)pk2(hh.x, hh.y) | ((unsigned long long)pk2(hh.z, hh.w) << 32);
#pragma unroll
                for (int r = 0; r < 16; ++r) { const f32x4 w = ((LAS f32x4*)WG)[r * 256 + lane + 64 * j]; a[r] += (hh.x * w.x + hh.y * w.y) + (hh.z * w.z + hh.w * w.w); if ((r & 3) == 3) asm volatile("" ::: "memory"); }
            }
            const bool b5 = lane & 32, b4 = lane & 16, b3 = lane & 8, b2 = lane & 4;
            float a8[8], a4[4], a2[2], a1;
#pragma unroll
            for (int r = 0; r < 8; ++r) { const float keep = b5 ? a[r + 8] : a[r], send = b5 ? a[r] : a[r + 8]; a8[r] = keep + __shfl_xor(send, 32); }
#pragma unroll
            for (int r = 0; r < 4; ++r) { const float keep = b4 ? a8[r + 4] : a8[r], send = b4 ? a8[r] : a8[r + 4]; a4[r] = keep + __shfl_xor(send, 16); }
#pragma unroll
            for (int r = 0; r < 2; ++r) { const float keep = b3 ? a4[r + 2] : a4[r], send = b3 ? a4[r] : a4[r + 2]; a2[r] = keep + __shfl_xor(send, 8); }
            { const float keep = b2 ? a2[1] : a2[0], send = b2 ? a2[0] : a2[1]; a1 = keep + __shfl_xor(send, 4); }
            a1 += __shfl_xor(a1, 2); a1 += __shfl_xor(a1, 1);
            if ((lane & 3) == 0) F.gklr[(size_t)row * 16 + (lane >> 2)] = a1;
        }
    }
}

constexpr int A_GL = 0, A_SEG = 4096, A_QE = 8192, A_KE = A_QE + 64 * 272, A_VT = A_KE + 64 * 272, A_PP = A_VT + 256 * 144, A_END = A_PP + 64 * 144;
static_assert(A_END <= RING_BYTES, "P3a LDS");
__device__ __forceinline__ void p3a_gla_chunk(Frame& F) {
    const int tid = F.tid, lane = F.lane, wave = F.wave, r32 = lane & 31, hi = lane >> 5;
    LAS float* GL = (LAS float*)(F.lds + A_GL); LAS float* SEG = (LAS float*)(F.lds + A_SEG);
    LAS bf16* QEl = (LAS bf16*)(F.lds + A_QE); LAS bf16* KEl = (LAS bf16*)(F.lds + A_KE); LAS bf16* VTl = (LAS bf16*)(F.lds + A_VT); LAS bf16* PPl = (LAS bf16*)(F.lds + A_PP);
    for (int u = F.vcu; u < 1024; u += F.G) {
        const int bh = u >> 5, c = u & 31, b = bh >> 2, h = bh & 3, t0 = b * T + c * 64;
        if (tid < 256) ((LAS f32x4*)GL)[tid] = ((const GAS f32x4*)(F.gklr + (size_t)t0 * 16))[tid];
        { const int tok = tid & 63, blk = tid >> 6; const GAS v4u* vp = (const GAS v4u*)(F.QKVG + (size_t)(t0 + tok) * NQKVG + 1024 + h * 256 + blk * 32);
#pragma unroll
          for (int q = 0; q < 4; ++q) { const v4u w = vp[q];
              LAS bf16* dst = VTl + (blk * 32 + q * 8) * 72 + tok;
              dst[0 * 72] = (bf16)(w.x & 0xffff); dst[1 * 72] = (bf16)(w.x >> 16); dst[2 * 72] = (bf16)(w.y & 0xffff); dst[3 * 72] = (bf16)(w.y >> 16);
              dst[4 * 72] = (bf16)(w.z & 0xffff); dst[5 * 72] = (bf16)(w.z >> 16); dst[6 * 72] = (bf16)(w.w & 0xffff); dst[7 * 72] = (bf16)(w.w >> 16); } }
        __syncthreads();
        const int d = tid & 127, seg = tid >> 7;
        float cs[16];
        { float w2[16];
#pragma unroll
          for (int r = 0; r < 16; ++r) w2[r] = F.gla_w_gk2[r * 512 + h * 128 + d];
          const float bg = F.gla_b_gk[h * 128 + d]; float run = 0.f;
#pragma unroll
          for (int ii = 0; ii < 16; ++ii) { const int i = seg * 16 + ii; float pre = bg;
#pragma unroll
              for (int q = 0; q < 4; ++q) { const f32x4 g4 = ((LAS f32x4*)GL)[i * 4 + q]; pre += g4.x * w2[4 * q] + g4.y * w2[4 * q + 1] + g4.z * w2[4 * q + 2] + g4.w * w2[4 * q + 3]; }
              run += -softplus_f(-pre) * (1.f / 16.f); cs[ii] = run; }
          SEG[seg * 128 + d] = run; }
        __syncthreads();
        float prefix = 0.f, total = 0.f;
#pragma unroll
        for (int s = 0; s < 4; ++s) { const float v = SEG[s * 128 + d]; total += v; if (s < seg) prefix += v; }
        float kte[16];
#pragma unroll
        for (int ii = 0; ii < 16; ++ii) { const int i = seg * 16 + ii; const float bb = prefix + cs[ii];
            const GAS bf16* rowp = (const GAS bf16*)(F.QKVG + (size_t)(t0 + i) * NQKVG + h * 128 + d);
            const float qv = bf2f(rowp[0]), kv = bf2f(rowp[512]);
            const unsigned qe = f2bf(qv * GLA_QSCALE * __expf(bb)), ke = f2bf(kv * __expf(-bb)); kte[ii] = kv * __expf(total - bb);
            QEl[i * 136 + d] = (bf16)qe; KEl[i * 136 + d] = (bf16)ke; F.QE[(size_t)(t0 + i) * 512 + h * 128 + d] = (bf16)qe; }
        { v4u w0, w1; w0.x = pk2(kte[0], kte[1]); w0.y = pk2(kte[2], kte[3]); w0.z = pk2(kte[4], kte[5]); w0.w = pk2(kte[6], kte[7]);
          w1.x = pk2(kte[8], kte[9]); w1.y = pk2(kte[10], kte[11]); w1.z = pk2(kte[12], kte[13]); w1.w = pk2(kte[14], kte[15]);
          GAS v4u* kp = (GAS v4u*)(F.KTET + ((size_t)u * 128 + d) * 64 + seg * 16); kp[0] = w0; kp[1] = w1; }
        if (seg == 0) F.dec[(size_t)u * 128 + d] = __expf(total);
        __syncthreads();
        if (wave < 3) {
            const int ib = wave > 0 ? 1 : 0, jb = wave == 2 ? 1 : 0;
            f32x16 acc;
#pragma unroll
            for (int r = 0; r < 16; ++r) acc[r] = 0.f;
#pragma unroll
            for (int ks = 0; ks < 8; ++ks) { const bf16x8 a = *(const LAS bf16x8*)(QEl + (ib * 32 + r32) * 136 + ks * 16 + 8 * hi), bb = *(const LAS bf16x8*)(KEl + (jb * 32 + r32) * 136 + ks * 16 + 8 * hi);
                acc = mfma32(a, bb, acc); }
#pragma unroll
            for (int r = 0; r < 16; ++r) { const int i = ib * 32 + crow(r, hi), j = jb * 32 + r32; PPl[i * 72 + j] = (bf16)f2bf(j <= i ? acc[r] : 0.f); }
        } else if (wave == 3) {
#pragma unroll
            for (int e = 0; e < 16; ++e) PPl[(2 * e + hi) * 72 + 32 + r32] = (bf16)0;
        }
        __syncthreads();
        { f32x16 acc0, acc1;
#pragma unroll
          for (int r = 0; r < 16; ++r) { acc0[r] = 0.f; acc1[r] = 0.f; }
#pragma unroll
          for (int ks = 0; ks < 4; ++ks) { const bf16x8 bb = *(const LAS bf16x8*)(VTl + (wave * 32 + r32) * 72 + ks * 16 + 8 * hi);
              const bf16x8 a0 = *(const LAS bf16x8*)(PPl + r32 * 72 + ks * 16 + 8 * hi), a1 = *(const LAS bf16x8*)(PPl + (32 + r32) * 72 + ks * 16 + 8 * hi);
              acc0 = mfma32(a0, bb, acc0); acc1 = mfma32(a1, bb, acc1); }
          GAS float* op = (GAS float*)(F.O + (size_t)t0 * 1024 + h * 256 + wave * 32 + r32);
#pragma unroll
          for (int r = 0; r < 16; ++r) { op[(size_t)crow(r, hi) * 1024] = acc0[r]; op[(size_t)(32 + crow(r, hi)) * 1024] = acc1[r]; } }
        { const int row = tid >> 1, half = tid & 1; const LAS v4u* sp = (const LAS v4u*)(VTl + row * 72 + half * 32); GAS v4u* dp = (GAS v4u*)(F.VT + ((size_t)u * 256 + row) * 64 + half * 32);
#pragma unroll
          for (int q = 0; q < 4; ++q) dp[q] = sp[q]; }
        __syncthreads();
    }
}

__device__ __forceinline__ void p3b_gla_scan(Frame& F) {
    const int tid = F.tid, lane = F.lane, wave = F.wave, r32 = lane & 31, hi = lane >> 5;
    LAS bf16* ST = (LAS bf16*)(F.lds);
    for (int u2 = F.vcu; u2 < 256; u2 += F.G) {
        const int bh = u2 >> 3, s = u2 & 7, b = bh >> 2, h = bh & 3;
        __syncthreads();
        for (int i = tid; i < 2 * 32 * 136 / 8; i += NTHR) ((LAS v4u*)ST)[i] = (v4u){0u, 0u, 0u, 0u};
        __syncthreads();
        if (wave < 4) {
            f32x16 S;
#pragma unroll
            for (int r = 0; r < 16; ++r) S[r] = 0.f;
            bf16x8 An[4], Bn[4]; f32x4 dn[4];
            { const int u = bh * 32;
              const GAS bf16x8* ap = (const GAS bf16x8*)(F.KTET + ((size_t)u * 128 + wave * 32 + r32) * 64 + 8 * hi); const GAS bf16x8* bp = (const GAS bf16x8*)(F.VT + ((size_t)u * 256 + s * 32 + r32) * 64 + 8 * hi);
#pragma unroll
              for (int ks = 0; ks < 4; ++ks) { An[ks] = ap[2 * ks]; Bn[ks] = bp[2 * ks]; }
              const GAS f32x4* dp = (const GAS f32x4*)(F.dec + (size_t)u * 128 + wave * 32 + 4 * hi);
#pragma unroll
              for (int g = 0; g < 4; ++g) dn[g] = dp[2 * g]; }
            for (int c = 0; c < 32; ++c) {
                bf16x8 Ac[4], Bc[4]; f32x4 dc[4];
#pragma unroll
                for (int ks = 0; ks < 4; ++ks) { Ac[ks] = An[ks]; Bc[ks] = Bn[ks]; dc[ks] = dn[ks]; }
                if (c + 1 < 32) { const int u = bh * 32 + c + 1;
                    const GAS bf16x8* ap = (const GAS bf16x8*)(F.KTET + ((size_t)u * 128 + wave * 32 + r32) * 64 + 8 * hi); const GAS bf16x8* bp = (const GAS bf16x8*)(F.VT + ((size_t)u * 256 + s * 32 + r32) * 64 + 8 * hi);
#pragma unroll
                    for (int ks = 0; ks < 4; ++ks) { An[ks] = ap[2 * ks]; Bn[ks] = bp[2 * ks]; }
                    const GAS f32x4* dp = (const GAS f32x4*)(F.dec + (size_t)u * 128 + wave * 32 + 4 * hi);
#pragma unroll
                    for (int g = 0; g < 4; ++g) dn[g] = dp[2 * g]; }
#pragma unroll
                for (int g = 0; g < 4; ++g) { S[4 * g] *= dc[g].x; S[4 * g + 1] *= dc[g].y; S[4 * g + 2] *= dc[g].z; S[4 * g + 3] *= dc[g].w; }
#pragma unroll
                for (int ks = 0; ks < 4; ++ks) S = mfma32(Ac[ks], Bc[ks], S);
                LAS bf16* st = ST + ((c + 1) & 1) * (32 * 136) + r32 * 136 + wave * 32 + 4 * hi;
#pragma unroll
                for (int g = 0; g < 4; ++g) { u32x2 w; w.x = pk2(S[4 * g], S[4 * g + 1]); w.y = pk2(S[4 * g + 2], S[4 * g + 3]); *(LAS u32x2*)(st + 8 * g) = w; }
                __syncthreads();
            }
        } else if (wave < 6) {
            const int ib = wave - 4;
            for (int c = 0; c < 32; ++c) {
                const int t0 = b * T + c * 64;
                const GAS bf16x8* ap = (const GAS bf16x8*)(F.QE + (size_t)(t0 + ib * 32 + r32) * 512 + h * 128 + 8 * hi);
                const LAS bf16x8* bp = (const LAS bf16x8*)(ST + (c & 1) * (32 * 136) + r32 * 136 + 8 * hi);
                GAS float* op = (GAS float*)(F.O + (size_t)(t0 + ib * 32) * 1024 + h * 256 + s * 32 + r32);
                bf16x8 a[8]; float o[16];
#pragma unroll
                for (int ks = 0; ks < 8; ++ks) a[ks] = ap[2 * ks];
#pragma unroll
                for (int r = 0; r < 16; ++r) o[r] = op[(size_t)crow(r, hi) * 1024];
                f32x16 acc;
#pragma unroll
                for (int r = 0; r < 16; ++r) acc[r] = 0.f;
#pragma unroll
                for (int ks = 0; ks < 8; ++ks) acc = mfma32(a[ks], bp[2 * ks], acc);
#pragma unroll
                for (int r = 0; r < 16; ++r) op[(size_t)crow(r, hi) * 1024] = o[r] + acc[r];
                __syncthreads();
            }
        } else {
            for (int c = 0; c < 32; ++c) __syncthreads();
        }
    }
}

__device__ __forceinline__ void p4_onorm(Frame& F) {
    const int gw = F.vcu * NWAVES + F.wave, NGW = F.G * NWAVES, lane = F.lane;
    const f32x4 og = ((const GAS f32x4*)F.gla_o_gain)[lane];
    for (int row = gw; row < M; row += NGW) {
        const GAS f32x4* orow = (const GAS f32x4*)(F.O + (size_t)row * 1024) + lane;
        const GAS u32x2* grow = (const GAS u32x2*)(F.QKVG + (size_t)row * NQKVG + 2048) + lane;
        GAS u32x2* dst = (GAS u32x2*)(F.ON + (size_t)row * 1024) + lane;
        f32x4 v[4]; u32x2 g[4];
#pragma unroll
        for (int j = 0; j < 4; ++j) { v[j] = orow[64 * j]; g[j] = grow[64 * j]; }
#pragma unroll
        for (int j = 0; j < 4; ++j) { const float ss = wave_sum((v[j].x * v[j].x + v[j].y * v[j].y) + (v[j].z * v[j].z + v[j].w * v[j].w)); const float rstd = rsqrtf(ss * (1.f / 256.f) + RMS_EPS);
            const f32x4 y = v[j] * rstd * og; u32x2 w; w.x = pk2(y.x * silu_f(bflo(g[j].x)), y.y * silu_f(bfhi(g[j].x))); w.y = pk2(y.z * silu_f(bflo(g[j].y)), y.w * silu_f(bfhi(g[j].y))); dst[64 * j] = w; }
    }
}

__device__ __forceinline__ void p6_x1norm(Frame& F) {
    LAS float* TB = (LAS float*)(F.lds);
    const int lane = F.lane;
    for (int rb = F.vcu; rb < M / 64; rb += F.G) {
        const int b = rb >> 5; const float* cb = F.cond + (size_t)b * NCOND;
        __syncthreads();
        for (int k = F.tid; k < 1024; k += NTHR) { TB[k] = F.kv_gain[k] * (1.f + cb[7168 + k]); TB[1024 + k] = cb[6144 + k]; TB[2048 + k] = F.norm_gain[1024 + k] * (1.f + cb[4096 + k]); TB[3072 + k] = cb[3072 + k]; }
        __syncthreads();
        for (int i = 0; i < 8; ++i) {
            const int row = rb * 64 + F.wave * 8 + i;
            const GAS f32x4* xr = (const GAS f32x4*)(F.out + (size_t)row * D) + lane;
            f32x4 v[4]; float ss = 0.f;
#pragma unroll
            for (int j = 0; j < 4; ++j) { v[j] = xr[64 * j]; ss += (v[j].x * v[j].x + v[j].y * v[j].y) + (v[j].z * v[j].z + v[j].w * v[j].w); }
            const float rstd = rsqrtf(wave_sum(ss) * (1.f / D) + RMS_EPS);
            GAS unsigned long long* oK = (GAS unsigned long long*)(F.XNKV + (size_t)row * D) + lane; GAS unsigned long long* oS = (GAS unsigned long long*)(F.XNSB + (size_t)row * D) + lane;
#pragma unroll
            for (int j = 0; j < 4; ++j) { const f32x4 xn = v[j] * rstd;
                const f32x4 hk = xn * ((LAS f32x4*)TB)[lane + 64 * j] + ((LAS f32x4*)TB)[256 + lane + 64 * j], hs = xn * ((LAS f32x4*)TB)[512 + lane + 64 * j] + ((LAS f32x4*)TB)[768 + lane + 64 * j];
                oK[64 * j] = (unsigned long long)pk2(hk.x, hk.y) | ((unsigned long long)pk2(hk.z, hk.w) << 32); oS[64 * j] = (unsigned long long)pk2(hs.x, hs.y) | ((unsigned long long)pk2(hs.z, hs.w) << 32); }
        }
    }
}

__device__ __forceinline__ void p8_sb_attn(Frame& F) {
    const int gw = F.vcu * NWAVES + F.wave, NGW = F.G * NWAVES, lane = F.lane, r32 = lane & 31, hi = lane >> 5;
    for (int uu = gw; uu < 8192; uu += NGW) {
        const int qb = 63 - (uu >> 7), bh = uu & 127, b = bh >> 4, h = bh & 15, q0 = qb * 32;
        const size_t rowbase = (size_t)b * T;
        bf16x8 qr[4];
        { const GAS bf16x8* qp = (const GAS bf16x8*)(F.QG + (rowbase + q0 + r32) * 2048 + h * 64 + 8 * hi);
#pragma unroll
          for (int d0 = 0; d0 < 4; ++d0) qr[d0] = qp[2 * d0]; }
        float Arun = 0.f; f32x16 o0, o1;
#pragma unroll
        for (int r = 0; r < 16; ++r) { o0[r] = 0.f; o1[r] = 0.f; }
        for (int jt = qb; jt >= 0; --jt) {
            const int k0 = jt * 32;
            const GAS bf16x8* kp = (const GAS bf16x8*)(F.KV + (rowbase + k0 + r32) * 2048 + h * 64 + 8 * hi);
            bf16x8 kf[4];
#pragma unroll
            for (int d0 = 0; d0 < 4; ++d0) kf[d0] = kp[2 * d0];
            const GAS bf16* vp = (const GAS bf16*)(F.KV + (rowbase + k0 + 4 * hi) * 2048 + 1024 + h * 64 + r32);
            bf16 vv[2][2][8];
#pragma unroll
            for (int s = 0; s < 2; ++s)
#pragma unroll
                for (int nt = 0; nt < 2; ++nt)
#pragma unroll
                    for (int j = 0; j < 8; ++j) vv[s][nt][j] = vp[(size_t)(16 * s + 8 * (j >> 2) + (j & 3)) * 2048 + nt * 32];
            f32x16 p;
#pragma unroll
            for (int r = 0; r < 16; ++r) p[r] = 0.f;
#pragma unroll
            for (int d0 = 0; d0 < 4; ++d0) p = mfma32(kf[d0], qr[d0], p);
            const bool diag = (jt == qb);
            float sp[16], loc[16], Tg[4], Og[4];
#pragma unroll
            for (int r = 0; r < 16; ++r) { const bool valid = !diag || (crow(r, hi) < r32); sp[r] = valid ? softplus_f(p[r]) : 0.f; }
#pragma unroll
            for (int g = 0; g < 4; ++g) { loc[4 * g + 3] = sp[4 * g + 3]; loc[4 * g + 2] = loc[4 * g + 3] + sp[4 * g + 2]; loc[4 * g + 1] = loc[4 * g + 2] + sp[4 * g + 1]; loc[4 * g] = loc[4 * g + 1] + sp[4 * g]; Tg[g] = loc[4 * g]; }
#pragma unroll
            for (int g = 0; g < 4; ++g) Og[g] = __shfl_xor(Tg[g], 32);
            float run = Arun, w[16];
#pragma unroll
            for (int g = 3; g >= 0; --g) { const float after = run + (hi == 0 ? Og[g] : 0.f); run += Tg[g] + Og[g];
#pragma unroll
                for (int e = 0; e < 4; ++e) { const int r = 4 * g + e; const bool valid = !diag || (crow(r, hi) < r32); w[r] = valid ? __expf(p[r] - (after + loc[r])) : 0.f; } }
            Arun = run;
#pragma unroll
            for (int s = 0; s < 2; ++s) { const bf16x8 pa = pack8(w[8 * s], w[8 * s + 1], w[8 * s + 2], w[8 * s + 3], w[8 * s + 4], w[8 * s + 5], w[8 * s + 6], w[8 * s + 7]);
                const bf16x8 v0 = (bf16x8){(short)vv[s][0][0], (short)vv[s][0][1], (short)vv[s][0][2], (short)vv[s][0][3], (short)vv[s][0][4], (short)vv[s][0][5], (short)vv[s][0][6], (short)vv[s][0][7]};
                const bf16x8 v1 = (bf16x8){(short)vv[s][1][0], (short)vv[s][1][1], (short)vv[s][1][2], (short)vv[s][1][3], (short)vv[s][1][4], (short)vv[s][1][5], (short)vv[s][1][6], (short)vv[s][1][7]};
                o0 = mfma32(pa, v0, o0); o1 = mfma32(pa, v1, o1); }
            if (jt > 0 && __all(Arun > SB_EXIT)) break;
        }
        const GAS bf16* gp = (const GAS bf16*)(F.QG + (rowbase + q0) * 2048 + 1024 + h * 64 + r32);
        GAS bf16* op = (GAS bf16*)(F.OG + (rowbase + q0) * 1024 + h * 64 + r32);
#pragma unroll
        for (int r = 0; r < 16; ++r) { const int q = crow(r, hi);
            op[(size_t)q * 1024] = (bf16)f2bf(o0[r] * silu_f(bf2f(gp[(size_t)q * 2048]))); op[(size_t)q * 1024 + 32] = (bf16)f2bf(o1[r] * silu_f(bf2f(gp[(size_t)q * 2048 + 32]))); }
    }
}

__device__ __forceinline__ void p10_final(Frame& F) {
    const int gw = F.vcu * NWAVES + F.wave, NGW = F.G * NWAVES, lane = F.lane;
    f32x4 fg[4];
#pragma unroll
    for (int j = 0; j < 4; ++j) fg[j] = ((const GAS f32x4*)F.final_gain)[lane + 64 * j];
    for (int row = gw; row < M; row += NGW) {
        GAS f32x4* xr = (GAS f32x4*)(F.out + (size_t)row * D) + lane;
        f32x4 v[4]; float ss = 0.f;
#pragma unroll
        for (int j = 0; j < 4; ++j) { v[j] = xr[64 * j]; ss += (v[j].x * v[j].x + v[j].y * v[j].y) + (v[j].z * v[j].z + v[j].w * v[j].w); }
        const float rstd = rsqrtf(wave_sum(ss) * (1.f / D) + RMS_EPS);
#pragma unroll
        for (int j = 0; j < 4; ++j) xr[64 * j] = v[j] * rstd * fg[j];
    }
}

constexpr int N_PHASES = 12;
#ifndef MK_ONE_LAUNCH
#define MK_ONE_LAUNCH 0
#endif
#ifndef MK_OPT_MASK
#define MK_OPT_MASK 0xFFF
#endif
struct Args { const float* in[17]; float* out; unsigned char* ws; int ph_lo, ph_hi; };
static_assert(sizeof(Args) == 19 * 8 + 8, "Args has no padding");

__global__ void __launch_bounds__(NTHR, 2) yoco_fwd(Args args) {
    extern __shared__ __attribute__((aligned(16))) unsigned char lds[];
    Frame F;
    F.lds = (LAS unsigned char*)lds;
    F.MISC = (volatile LAS unsigned*)(F.lds + MISC_OFF);
    F.tid = threadIdx.x; F.lane = F.tid & 63; F.wave = __builtin_amdgcn_readfirstlane(F.tid >> 6);
    F.G = gridDim.x; { const int bx = blockIdx.x; F.vcu = (F.G % 8 == 0) ? (bx % 8) * (F.G / 8) + bx / 8 : bx; }
    unsigned char* ws = args.ws;
    F.ctl = (gu32*)(ws + WS_CTL);
    F.x = args.in[0]; F.c = args.in[1]; F.norm_gain = args.in[2]; F.w_ada = args.in[3]; F.b_ada = args.in[4]; F.gla_w_in = args.in[5]; F.gla_w_gk2 = args.in[6]; F.gla_b_gk = args.in[7];
    F.gla_o_gain = args.in[8]; F.gla_w_out = args.in[9]; F.kv_gain = args.in[10]; F.kv_w_ada = args.in[11]; F.kv_b_ada = args.in[12]; F.w_kv = args.in[13]; F.sb_w_in = args.in[14];
    F.sb_w_out = args.in[15]; F.final_gain = args.in[16]; F.out = args.out;
    F.Win_t = (bf16*)(ws + WS_WIN); F.Wout_t = (bf16*)(ws + WS_WOUT); F.Wkv_t = (bf16*)(ws + WS_WKV); F.Wsbi_t = (bf16*)(ws + WS_WSBI); F.Wsbo_t = (bf16*)(ws + WS_WSBO);
    F.condp = (float*)(ws + WS_CONDP); F.cond = (float*)(ws + WS_COND); F.gklr = (float*)(ws + WS_GKLR); F.dec = (float*)(ws + WS_DEC); F.O = (float*)(ws + WS_O);
    F.XN = (bf16*)(ws + WS_XN); F.QE = (bf16*)(ws + WS_QE); F.KTET = (bf16*)(ws + WS_KTET); F.QKVG = (bf16*)(ws + WS_QKVG); F.KV = (bf16*)(ws + WS_KV); F.QG = (bf16*)(ws + WS_QG);
    F.OG = (bf16*)(ws + WS_OG); F.ON = (bf16*)(ws + WS_ON); F.VT = (bf16*)(ws + WS_ON); F.XNKV = (bf16*)(ws + WS_XN); F.XNSB = (bf16*)(ws + WS_ON);
    for (int u = F.tid; u < (LDS_BYTES - LDSCTL_OFF) / 4; u += NTHR) ((LAS unsigned*)(F.lds + LDSCTL_OFF))[u] = 0u;
    __syncthreads();
    const int lo = args.ph_lo, hi = args.ph_hi;
    const bool multi = (hi - lo) > 1;
    XcdBarrier bar; bar.bar = (unsigned*)(F.ctl + CW_BAR); bar.x = 0; bar.st = nullptr;
    if (multi) bar = xcd_barrier_post((unsigned*)(F.ctl + CW_BAR), F.MISC + 8);
#ifndef MK_PHASE_MASK
#define MK_PHASE_MASK 0xFFF
#endif
#define IN(k) (((MK_PHASE_MASK >> (k)) & 1) && lo <= (k) && (k) < hi)
#define SEAM(k) do { if (IN(k) && IN((k) + 1)) xcd_barrier(bar); } while (0)
    LAS unsigned char* ring = F.lds;

    if (IN(0)) { p0_prologue(F); } SEAM(0);
    if (IN(1)) { p1_xnorm(F); } SEAM(1);
    if (IN(2)) {
        pg8::Gemm g{F.XN, F.Win_t, M, NQKVG, D}; pg8::StaticOrder S; S.init(M, NQKVG, F.G, (int)blockIdx.x);
        pg8::EpiBf16<0> E{F.QKVG, NQKVG, nullptr, 0, 0, 1.f};
        pg8::gemm_phase<pg8::EpiBf16<0>, pg8::StaticOrder, true, true>(ring, g, S, E);
    } SEAM(2);
    if (IN(3)) { p3a_gla_chunk(F); } SEAM(3);
    if (IN(4)) { p3b_gla_scan(F); } SEAM(4);
    if (IN(5)) { p4_onorm(F); } SEAM(5);
    if (IN(6)) {
        pg8::Gemm g{F.ON, F.Wout_t, M, D, D}; pg8::StaticOrder S; S.init(M, D, F.G, (int)blockIdx.x);
        pg8::EpiRes E{F.x, F.out, F.cond + 2048, NCOND};
        pg8::gemm_phase<pg8::EpiRes, pg8::StaticOrder, true, true>(ring, g, S, E);
    } SEAM(6);
    if (IN(7)) { p6_x1norm(F); } SEAM(7);
    if (IN(8)) {
        { pg8::Gemm g{F.XNKV, F.Wkv_t, M, 2048, D}; pg8::StaticOrder S; S.init(M, 2048, F.G, (int)blockIdx.x);
          pg8::EpiBf16<0> E{F.KV, 2048, nullptr, 0, 0, 1.f};
          pg8::gemm_phase<pg8::EpiBf16<0>, pg8::StaticOrder, true, true>(ring, g, S, E); }
        { pg8::Gemm g{F.XNSB, F.Wsbi_t, M, 2048, D}; pg8::StaticOrder S; S.init(M, 2048, F.G, (int)blockIdx.x);
          pg8::EpiBf16<0> E{F.QG, 2048, nullptr, 1024, 1024, 0.125f};
          pg8::gemm_phase<pg8::EpiBf16<0>, pg8::StaticOrder, true, true>(ring, g, S, E); }
    } SEAM(8);
    if (IN(9)) { p8_sb_attn(F); } SEAM(9);
    if (IN(10)) {
        pg8::Gemm g{F.OG, F.Wsbo_t, M, D, D}; pg8::StaticOrder S; S.init(M, D, F.G, (int)blockIdx.x);
        pg8::EpiRes E{F.out, F.out, F.cond + 5120, NCOND};
        pg8::gemm_phase<pg8::EpiRes, pg8::StaticOrder, true, true>(ring, g, S, E);
    } SEAM(10);
    if (IN(11)) { p10_final(F); }
#undef IN
#undef SEAM
}

namespace nv {
__global__ void cond_k(const float* c, const float* w_ada, const float* b_ada, const float* kv_w, const float* kv_b, float* cond) {
    const int n = blockIdx.x * blockDim.x + threadIdx.x; if (n >= NCOND) return;
    const float* W; int ld, col; float bias;
    if (n < 6144) { const int l = n / 3072; col = n - l * 3072; W = w_ada + (size_t)l * 1024 * 3072; ld = 3072; bias = b_ada[n]; } else { col = n - 6144; W = kv_w; ld = 2048; bias = kv_b[col]; }
    float acc[8];
#pragma unroll
    for (int b = 0; b < 8; ++b) acc[b] = 0.f;
    for (int k = 0; k < 1024; ++k) { const float w = W[(size_t)k * ld + col];
#pragma unroll
        for (int b = 0; b < 8; ++b) { const float cv = c[b * 1024 + k]; acc[b] += cv / (1.f + expf(-cv)) * w; } }
#pragma unroll
    for (int b = 0; b < 8; ++b) cond[(size_t)b * NCOND + n] = acc[b] + bias;
}
__global__ void modnorm_k(const float* src, const float* gain, const float* cond, int shift_off, int scale_off, bf16* dst, const float* w_in, float* gklr) {
    const int row = blockIdx.x * (blockDim.x >> 6) + (threadIdx.x >> 6), lane = threadIdx.x & 63; if (row >= M) return;
    const int b = row / T; const float* cb = cond + (size_t)b * NCOND;
    float v[16], ss = 0.f;
#pragma unroll
    for (int e = 0; e < 16; ++e) { v[e] = src[(size_t)row * D + lane + 64 * e]; ss += v[e] * v[e]; }
    const float rstd = 1.f / sqrtf(wave_sum(ss) / D + RMS_EPS);
#pragma unroll
    for (int e = 0; e < 16; ++e) { const int k = lane + 64 * e; v[e] = v[e] * rstd * gain[k] * (1.f + cb[scale_off + k]) + cb[shift_off + k]; dst[(size_t)row * D + k] = (bf16)f2bf(v[e]); }
    if (gklr) for (int r = 0; r < 16; ++r) { float p = 0.f;
#pragma unroll
        for (int e = 0; e < 16; ++e) p += v[e] * w_in[(size_t)(lane + 64 * e) * GIN + NQKVG + r];
        p = wave_sum(p); if (lane == 0) gklr[(size_t)row * 16 + r] = p; }
}
template <int MODE> __global__ void __launch_bounds__(256) gemm_k(const bf16* A, const float* W, int ldw, int N, int K, bf16* O, int ldo, int scale_cols, float scale, const float* base, float* out, const float* gate) {
    __shared__ float As[16][65], Bs[16][65];
    const int tx = threadIdx.x & 15, ty = threadIdx.x >> 4, m0 = blockIdx.y * 64, n0 = blockIdx.x * 64;
    float acc[4][4];
#pragma unroll
    for (int i = 0; i < 4; ++i)
#pragma unroll
        for (int j = 0; j < 4; ++j) acc[i][j] = 0.f;
    for (int k0 = 0; k0 < K; k0 += 16) {
#pragma unroll
        for (int q = 0; q < 4; ++q) { const int idx = threadIdx.x + 256 * q; const int mm = idx >> 4, kk = idx & 15; As[kk][mm] = bf2f(A[(size_t)(m0 + mm) * K + k0 + kk]);
            const int kk2 = idx >> 6, nn = idx & 63; Bs[kk2][nn] = bf2f((bf16)f2bf(W[(size_t)(k0 + kk2) * ldw + n0 + nn])); }
        __syncthreads();
#pragma unroll
        for (int kk = 0; kk < 16; ++kk) { float a[4], b[4];
#pragma unroll
            for (int i = 0; i < 4; ++i) { a[i] = As[kk][ty * 4 + i]; b[i] = Bs[kk][tx * 4 + i]; }
#pragma unroll
            for (int i = 0; i < 4; ++i)
#pragma unroll
                for (int j = 0; j < 4; ++j) acc[i][j] += a[i] * b[j]; }
        __syncthreads();
    }
#pragma unroll
    for (int i = 0; i < 4; ++i)
#pragma unroll
        for (int j = 0; j < 4; ++j) { const int m = m0 + ty * 4 + i, n = n0 + tx * 4 + j;
            if (MODE == 0) O[(size_t)m * ldo + n] = (bf16)f2bf(acc[i][j] * (n < scale_cols ? scale : 1.f));
            else out[(size_t)m * 1024 + n] = base[(size_t)m * 1024 + n] + gate[(size_t)(m / T) * NCOND + n] * acc[i][j]; }
}
__global__ void __launch_bounds__(256) gla_k(const bf16* QKVG, const float* gklr, const float* w_gk2, const float* b_gk, float* O) {
    const int bh = blockIdx.x, b = bh >> 2, h = bh & 3, tid = threadIdx.x;
    __shared__ float sq[128], sk[128], sdec[128];
    float S[128];
#pragma unroll
    for (int d = 0; d < 128; ++d) S[d] = 0.f;
    for (int t = 0; t < T; ++t) { const size_t row = (size_t)b * T + t;
        if (tid < 128) { const int d = tid; float pre = b_gk[h * 128 + d];
            for (int r = 0; r < 16; ++r) pre += gklr[row * 16 + r] * w_gk2[r * 512 + h * 128 + d];
            const float ls = fminf(pre, 0.f) - log1pf(expf(-fabsf(pre)));
            sdec[d] = expf(ls / 16.f); sq[d] = bf2f(QKVG[row * NQKVG + h * 128 + d]) * GLA_QSCALE; sk[d] = bf2f(QKVG[row * NQKVG + 512 + h * 128 + d]); }
        __syncthreads();
        const float v = bf2f(QKVG[row * NQKVG + 1024 + h * 256 + tid]); float o = 0.f;
#pragma unroll
        for (int d = 0; d < 128; ++d) { S[d] = sdec[d] * S[d] + sk[d] * v; o += sq[d] * S[d]; }
        O[row * 1024 + h * 256 + tid] = o;
        __syncthreads(); }
}
__global__ void __launch_bounds__(64) sb_k(const bf16* QG, const bf16* KV, bf16* OG, int early) {
    const int bh = blockIdx.x >> 5, tb = blockIdx.x & 31, b = bh >> 4, h = bh & 15, lane = threadIdx.x, t = tb * 64 + lane;
    const size_t rowbase = (size_t)b * T;
    float q[64], o[64];
#pragma unroll
    for (int d = 0; d < 64; ++d) { q[d] = bf2f(QG[(rowbase + t) * 2048 + h * 64 + d]); o[d] = 0.f; }
    float A = 0.f;
    for (int s = tb * 64 + 63; s >= 0; --s) { const bool valid = s < t; const bf16* kr = KV + (rowbase + s) * 2048 + h * 64;
        float z = 0.f;
#pragma unroll
        for (int d = 0; d < 64; ++d) z += q[d] * bf2f(kr[d]);
        const float sp = valid ? (fmaxf(z, 0.f) + log1pf(expf(-fabsf(z)))) : 0.f; A += sp; const float w = valid ? expf(z - A) : 0.f;
#pragma unroll
        for (int d = 0; d < 64; ++d) o[d] += w * bf2f(kr[1024 + d]);
        if (early && __all(A > SB_EXIT)) break; }
#pragma unroll
    for (int d = 0; d < 64; ++d) { const float g = bf2f(QG[(rowbase + t) * 2048 + 1024 + h * 64 + d]); OG[(rowbase + t) * 1024 + h * 64 + d] = (bf16)f2bf(o[d] * (g / (1.f + expf(-g)))); }
}
}

extern "C" void kernel_launch(void* const* d_in, const int* in_sizes, int n_in, void* d_out, int out_size, void* d_ws, size_t ws_size, hipStream_t stream) {
    static int grid = 0;
    if (grid == 0) {
        if (n_in != 17 || in_sizes[0] != M * D || out_size != M * D || ws_size < WS_END) { fprintf(stderr, "kernel_launch: unexpected shapes (n_in %d, in0 %d, out %d, ws %zu); nothing launched\n", n_in, n_in > 0 ? in_sizes[0] : -1, out_size, ws_size); grid = -1; return; }
        int dev = 0, cus = 0, per_cu = 0;
        if (hipGetDevice(&dev) != hipSuccess || hipDeviceGetAttribute(&cus, hipDeviceAttributeMultiprocessorCount, dev) != hipSuccess) { fprintf(stderr, "kernel_launch: device query failed\n"); grid = -1; return; }
        if (hipFuncSetAttribute((const void*)yoco_fwd, hipFuncAttributeMaxDynamicSharedMemorySize, LDS_BYTES) != hipSuccess) { fprintf(stderr, "kernel_launch: hipFuncSetAttribute failed\n"); grid = -1; return; }
        if (hipOccupancyMaxActiveBlocksPerMultiprocessor(&per_cu, (const void*)yoco_fwd, NTHR, LDS_BYTES) != hipSuccess || per_cu < 1) fprintf(stderr, "kernel_launch: note: occupancy query reports %d workgroups per CU\n", per_cu);
        (void)hipGetLastError();
        grid = cus;
    }
    if (grid < 0) return;
    if (hipMemsetAsync((char*)d_ws + WS_CTL, 0, CTL_ZERO_BYTES, stream) != hipSuccess) { fprintf(stderr, "kernel_launch: memset failed\n"); return; }
    Args a{};
    for (int i = 0; i < 17; ++i) a.in[i] = (const float*)d_in[i];
    a.out = (float*)d_out; a.ws = (unsigned char*)d_ws;
    unsigned char* ws = (unsigned char*)d_ws;
    const float* const* in = (const float* const*)d_in;
#if MK_ONE_LAUNCH
    a.ph_lo = 0; a.ph_hi = N_PHASES;
    hipLaunchKernelGGL(yoco_fwd, dim3(grid), dim3(NTHR), LDS_BYTES, stream, a);
#else
    const unsigned opt = MK_OPT_MASK;
    float* cond = (float*)(ws + WS_COND); float* gklr = (float*)(ws + WS_GKLR); float* O = (float*)(ws + WS_O);
    bf16 *XN = (bf16*)(ws + WS_XN), *QKVG = (bf16*)(ws + WS_QKVG), *KV = (bf16*)(ws + WS_KV), *QG = (bf16*)(ws + WS_QG), *OG = (bf16*)(ws + WS_OG), *ON = (bf16*)(ws + WS_ON);
    for (int p = 0; p < N_PHASES; ++p) {
        const bool use_opt = (opt >> p) & 1u;
        if (use_opt || p == 0 || p == 5 || p == 11) { a.ph_lo = p; a.ph_hi = p + 1; hipLaunchKernelGGL(yoco_fwd, dim3(grid), dim3(NTHR), LDS_BYTES, stream, a); if (p != 0 || use_opt) continue; }
        switch (p) {
        case 0: break;
        case 1: hipLaunchKernelGGL(nv::cond_k, dim3(NCOND / 256), dim3(256), 0, stream, in[1], in[3], in[4], in[11], in[12], cond);
                hipLaunchKernelGGL(nv::modnorm_k, dim3(M / 4), dim3(256), 0, stream, in[0], in[2], (const float*)cond, 0, 1024, XN, in[5], gklr); break;
        case 2: hipLaunchKernelGGL(nv::gemm_k<0>, dim3(NQKVG / 64, M / 64), dim3(256), 0, stream, (const bf16*)XN, in[5], GIN, NQKVG, D, QKVG, NQKVG, 0, 1.f, (const float*)nullptr, (float*)nullptr, (const float*)nullptr); break;
        case 3: hipLaunchKernelGGL(nv::gla_k, dim3(32), dim3(256), 0, stream, (const bf16*)QKVG, (const float*)gklr, in[6], in[7], O); break;
        case 4: break;
        case 6: hipLaunchKernelGGL(nv::gemm_k<1>, dim3(1024 / 64, M / 64), dim3(256), 0, stream, (const bf16*)ON, in[9], 1024, 1024, D, (bf16*)nullptr, 0, 0, 1.f, in[0], (float*)d_out, (const float*)(cond + 2048)); break;
        case 7: hipLaunchKernelGGL(nv::modnorm_k, dim3(M / 4), dim3(256), 0, stream, (const float*)d_out, in[10], (const float*)cond, 6144, 7168, XN, (const float*)nullptr, (float*)nullptr);
                hipLaunchKernelGGL(nv::modnorm_k, dim3(M / 4), dim3(256), 0, stream, (const float*)d_out, in[2] + 1024, (const float*)cond, 3072, 4096, ON, (const float*)nullptr, (float*)nullptr); break;
        case 8: hipLaunchKernelGGL(nv::gemm_k<0>, dim3(2048 / 64, M / 64), dim3(256), 0, stream, (const bf16*)XN, in[13], 2048, 2048, D, KV, 2048, 0, 1.f, (const float*)nullptr, (float*)nullptr, (const float*)nullptr);
                hipLaunchKernelGGL(nv::gemm_k<0>, dim3(2048 / 64, M / 64), dim3(256), 0, stream, (const bf16*)ON, in[14], 2048, 2048, D, QG, 2048, 1024, 0.125f, (const float*)nullptr, (float*)nullptr, (const float*)nullptr); break;
        case 9: hipLaunchKernelGGL(nv::sb_k, dim3(128 * 32), dim3(64), 0, stream, (const bf16*)QG, (const bf16*)KV, OG, 0); break;
        case 10: hipLaunchKernelGGL(nv::gemm_k<1>, dim3(1024 / 64, M / 64), dim3(256), 0, stream, (const bf16*)OG, in[15], 1024, 1024, D, (bf16*)nullptr, 0, 0, 1.f, (const float*)d_out, (float*)d_out, (const float*)(cond + 5120)); break;
        default: break;
        }
    }
#endif
}
```
